# Optimizing an MI355X kernel written in HIP

```python
import math
import jax, jax.numpy as jnp
from jax import lax
import numpy as np

D_MODEL = 1024
BATCH = 2
SEQ = 16384
DEPTH = 1

M_HEADS = 4
M_QK_DIM = 128
M_V_DIM = 256
M_QK = M_HEADS * M_QK_DIM
M_WIDTH = M_HEADS * M_V_DIM
M_CHUNK = 64
CONV_WIDTH = 4
A_HEADS = 8
A_HEAD_DIM = 64
A_V_DIM = 2 * A_HEAD_DIM
A_QK = A_HEADS * 2 * A_HEAD_DIM
A_WIDTH = A_HEADS * A_V_DIM
Q_BLOCK = 128
ROPE_THETA = 500000.0
ROPE_DIMS = A_HEAD_DIM // 4
EPS = 1e-6
SPLIT_SIZES = (2 * M_QK, M_WIDTH, 4 * M_HEADS, M_WIDTH, M_WIDTH, A_QK, A_QK, A_WIDTH, A_WIDTH, 2 * D_MODEL)
IN_COLS = sum(SPLIT_SIZES)

kernel_name = "hybrid_mlstm_diffattn_gated_block"


def _rmsnorm(x, g):
    xf = x.astype(jnp.float32)
    y = xf * lax.rsqrt(jnp.mean(xf * xf, axis=-1, keepdims=True) + EPS)
    return (y * g.astype(jnp.float32)).astype(x.dtype)


def _rope_partial(x):
    S = x.shape[-2]
    half = ROPE_DIMS // 2
    inv = ROPE_THETA ** (-jnp.arange(0, ROPE_DIMS, 2, dtype=jnp.float32) / ROPE_DIMS)
    ang = jnp.arange(S, dtype=jnp.float32)[:, None] * inv[None, :]
    cos, sin = jnp.cos(ang), jnp.sin(ang)
    xf = x.astype(jnp.float32)
    x1, x2, rest = xf[..., :half], xf[..., half:ROPE_DIMS], xf[..., ROPE_DIMS:]
    out = jnp.concatenate([x1 * cos - x2 * sin, x2 * cos + x1 * sin, rest], axis=-1)
    return out.astype(x.dtype)


def _centred_dwconv(x, w, b):
    C = x.shape[-1]
    left = CONV_WIDTH // 2
    y = lax.conv_general_dilated(x, w[:, None, :].astype(x.dtype), window_strides=(1,),
                                 padding=[(left, CONV_WIDTH - 1 - left)],
                                 dimension_numbers=('NWC', 'WIO', 'NWC'), feature_group_count=C)
    return y + b.astype(x.dtype)


def _mlstm_chunkwise(q, k, v, i_pre, log_f):
    N, H, S, dk = q.shape
    dv = v.shape[-1]
    L = M_CHUNK
    nc = S // L
    f32 = jnp.float32
    q = q.astype(f32) * (dk ** -0.5)

    def chunk(t):
        return jnp.moveaxis(t.astype(f32).reshape(t.shape[:2] + (nc, L) + t.shape[3:]), 2, 0)

    qc, kc, vc, ic = chunk(q), chunk(k), chunk(v), chunk(i_pre)
    ac = jnp.cumsum(chunk(log_f), axis=-1)
    causal = jnp.tril(jnp.ones((L, L), dtype=bool))

    def body(carry, xs):
        C, n, m = carry
        qb, kb, vb, ib, ab = xs
        D = ab[..., :, None] - ab[..., None, :] + ib[..., None, :]
        D = jnp.where(causal, D, -jnp.inf)
        inter = ab + m[..., None]
        mj = jnp.maximum(inter, jnp.max(D, axis=-1))
        w_inter = jnp.exp(inter - mj)
        s = jnp.einsum('nhjd,nhsd->nhjs', qb, kb) * jnp.exp(D - mj[..., None])
        num = w_inter[..., None] * jnp.einsum('nhjd,nhde->nhje', qb, C) + jnp.einsum('nhjs,nhse->nhje', s, vb)
        den = w_inter * jnp.einsum('nhjd,nhd->nhj', qb, n) + jnp.sum(s, axis=-1)
        h = num / jnp.maximum(jnp.abs(den), jnp.exp(-mj))[..., None]
        A = ab[..., -1]
        g = A[..., None] - ab + ib
        m_new = jnp.maximum(A + m, jnp.max(g, axis=-1))
        wk = jnp.exp(g - m_new[..., None])
        decay = jnp.exp(A + m - m_new)
        C_new = decay[..., None, None] * C + jnp.einsum('nhs,nhsd,nhse->nhde', wk, kb, vb)
        n_new = decay[..., None] * n + jnp.einsum('nhs,nhsd->nhd', wk, kb)
        return (C_new, n_new, m_new), h

    init = (jnp.zeros((N, H, dk, dv), f32), jnp.zeros((N, H, dk), f32), jnp.zeros((N, H), f32))
    _, hs = lax.scan(body, init, (qc, kc, vc, ic, ac))
    return jnp.moveaxis(hs, 0, 2).reshape(N, H, S, dv)


def _diff_attention(q, k, v, lam):
    B, H, _, S, dh = q.shape
    nb = S // Q_BLOCK
    scale = dh ** -0.5
    qb = jnp.moveaxis(q.reshape(B, H, 2, nb, Q_BLOCK, dh), 3, 0)

    def block(qblk):
        s = jnp.einsum('bhcqd,bhckd->bhcqk', qblk, k).astype(jnp.float32) * scale
        p = jax.nn.softmax(s, axis=-1)
        a = p[:, :, 0] - lam * p[:, :, 1]
        return jnp.einsum('bhqk,bhke->bhqe', a, v.astype(jnp.float32))

    out = lax.map(block, qb)
    return jnp.moveaxis(out, 0, 2).reshape(B, H, S, 2 * dh).astype(v.dtype)


def _layer(x, layer_idx, pre_g, w_in, conv_w, conv_b, gate_b, m_norm_g, lambda_qk, a_norm_g,
           w_branch_m, w_branch_a, b_merge, w_out, post_g):
    B, S, _ = x.shape
    xn = _rmsnorm(x, pre_g)
    proj = xn @ w_in
    cuts = [int(c) for c in np.cumsum(SPLIT_SIZES)[:-1]]
    m_qk, m_v, m_g, m_o, m_z, a_q, a_k, a_v, a_z, g_merge = jnp.split(proj, cuts, axis=-1)

    m_qk = jax.nn.silu(_centred_dwconv(m_qk, conv_w, conv_b))
    mq, mk = jnp.split(m_qk, 2, axis=-1)
    mq = mq.reshape(B, S, M_HEADS, M_QK_DIM).transpose(0, 2, 1, 3)
    mk = mk.reshape(B, S, M_HEADS, M_QK_DIM).transpose(0, 2, 1, 3)
    mv = m_v.reshape(B, S, M_HEADS, M_V_DIM).transpose(0, 2, 1, 3)
    gates = (m_g.reshape(B, S, 4, M_HEADS) + gate_b).astype(jnp.float32).transpose(2, 0, 3, 1)
    i_fw, f_fw, i_bw, f_bw = gates[0], gates[1], gates[2], gates[3]
    q2 = jnp.concatenate([mq, jnp.flip(mq, 2)], axis=0)
    k2 = jnp.concatenate([mk, jnp.flip(mk, 2)], axis=0)
    v2 = jnp.concatenate([mv, jnp.flip(mv, 2)], axis=0)
    i2 = jnp.concatenate([i_fw, jnp.flip(i_bw, -1)], axis=0)
    lf2 = jax.nn.log_sigmoid(jnp.concatenate([f_fw, jnp.flip(f_bw, -1)], axis=0))
    h2 = _mlstm_chunkwise(q2, k2, v2, i2, lf2)
    h = h2[:B] + jnp.flip(h2[B:], 2)
    h = _rmsnorm(h.transpose(0, 2, 1, 3), m_norm_g.reshape(M_HEADS, M_V_DIM)).astype(x.dtype)
    h_a = jax.nn.sigmoid(m_o) * h.reshape(B, S, M_WIDTH) * jax.nn.silu(m_z)

    aq = _rope_partial(a_q.reshape(B, S, A_HEADS, 2, A_HEAD_DIM).transpose(0, 2, 3, 1, 4))
    ak = _rope_partial(a_k.reshape(B, S, A_HEADS, 2, A_HEAD_DIM).transpose(0, 2, 3, 1, 4))
    av = a_v.reshape(B, S, A_HEADS, A_V_DIM).transpose(0, 2, 1, 3)
    lam_init = 0.8 - 0.6 * math.exp(-0.3 * layer_idx)
    lq = lambda_qk.astype(jnp.float32)
    lam = jnp.exp(jnp.sum(lq[0] * lq[1])) - jnp.exp(jnp.sum(lq[2] * lq[3])) + lam_init
    o = _diff_attention(aq, ak, av, lam)
    o = _rmsnorm(o, a_norm_g).astype(jnp.float32) * (1.0 - lam_init)
    o = o.astype(x.dtype).transpose(0, 2, 1, 3).reshape(B, S, A_WIDTH)
    h_b = o * jax.nn.silu(a_z)

    g = jax.nn.sigmoid(g_merge + b_merge)
    g_a, g_b = jnp.split(g, 2, axis=-1)
    y = g_a * (h_a @ w_branch_m) + g_b * (h_b @ w_branch_a)
    out = y @ w_out
    return x + _rmsnorm(out, post_g)


def setup_inputs(seed: int = 0) -> dict:
    key = jax.random.key(seed)
    ks = jax.random.split(key, 16)
    f32 = jnp.float32
    nrm = lambda k, shp, s: (jax.random.normal(k, shp, f32) * s)
    x = nrm(ks[0], (BATCH, SEQ, D_MODEL), 1.0)
    pre_norm_g = 1.0 + nrm(ks[1], (DEPTH, D_MODEL), 0.02)
    w_in = nrm(ks[2], (DEPTH, D_MODEL, IN_COLS), D_MODEL ** -0.5)
    conv_w = nrm(ks[3], (DEPTH, CONV_WIDTH, 2 * M_QK), CONV_WIDTH ** -0.5)
    conv_b = nrm(ks[4], (DEPTH, 2 * M_QK), 0.02)
    f_base = jnp.linspace(3.0, 6.0, M_HEADS, dtype=f32)
    zero = jnp.zeros((M_HEADS,), f32)
    gate_base = jnp.stack([zero, f_base, zero, f_base])[None]
    gate_b = gate_base + nrm(ks[5], (DEPTH, 4, M_HEADS), 0.1)
    m_norm_g = 1.0 + nrm(ks[6], (DEPTH, M_WIDTH), 0.02)
    lambda_qk = nrm(ks[7], (DEPTH, 4, A_HEAD_DIM), 0.1)
    a_norm_g = 1.0 + nrm(ks[8], (DEPTH, A_V_DIM), 0.02)
    w_branch_m = nrm(ks[9], (DEPTH, M_WIDTH, D_MODEL), M_WIDTH ** -0.5)
    w_branch_a = nrm(ks[10], (DEPTH, A_WIDTH, D_MODEL), A_WIDTH ** -0.5)
    b_merge = nrm(ks[11], (DEPTH, 2 * D_MODEL), 0.02)
    w_out = nrm(ks[12], (DEPTH, D_MODEL, D_MODEL), D_MODEL ** -0.5)
    post_norm_g = 1.0 + nrm(ks[13], (DEPTH, D_MODEL), 0.02)
    return {"x": x, "pre_norm_g": pre_norm_g, "w_in": w_in, "conv_w": conv_w, "conv_b": conv_b,
            "gate_b": gate_b, "m_norm_g": m_norm_g, "lambda_qk": lambda_qk, "a_norm_g": a_norm_g,
            "w_branch_m": w_branch_m, "w_branch_a": w_branch_a, "b_merge": b_merge, "w_out": w_out,
            "post_norm_g": post_norm_g}


def reference(x, pre_norm_g, w_in, conv_w, conv_b, gate_b, m_norm_g, lambda_qk, a_norm_g,
              w_branch_m, w_branch_a, b_merge, w_out, post_norm_g):
    for l in range(DEPTH):
        x = _layer(x, l, pre_norm_g[l], w_in[l], conv_w[l], conv_b[l], gate_b[l], m_norm_g[l],
                   lambda_qk[l], a_norm_g[l], w_branch_m[l], w_branch_a[l], b_merge[l], w_out[l],
                   post_norm_g[l])
    return x
```

```cpp
#include <hip/hip_runtime.h>
#include <hip/hip_cooperative_groups.h>
#include <cstdio>
#include <cstdint>
namespace cg = cooperative_groups;

typedef unsigned short bf16_t;
typedef short bf16x8 __attribute__((ext_vector_type(8)));
typedef short s16x4 __attribute__((ext_vector_type(4)));
typedef float f32x4 __attribute__((ext_vector_type(4)));
typedef float f32x8 __attribute__((ext_vector_type(8)));
typedef float f32x16 __attribute__((ext_vector_type(16)));
typedef unsigned u32x4 __attribute__((ext_vector_type(4)));
typedef unsigned u32x2 __attribute__((ext_vector_type(2)));
#define DI __device__ __forceinline__

constexpr int T = 32768, SEQ = 16384, DM = 1024;
constexpr float EPS = 1e-6f;
constexpr size_t MiB = (size_t)1 << 20;
constexpr size_t WS_XN = 0, WS_MQK = 64 * MiB, WS_MV = 128 * MiB, WS_OG = 192 * MiB, WS_AZ = 256 * MiB, WS_ST = 320 * MiB, WS_G = 384 * MiB, WS_END = 512 * MiB;
constexpr size_t WS_Y = WS_XN, WS_AQ = WS_MQK, WS_AK = WS_MV, WS_AV = WS_ST, WS_HA = WS_OG, WS_HB = WS_AZ;
constexpr size_t WS_WOT = WS_MQK;
constexpr size_t WS_ROWSQ = WS_MV;
constexpr size_t DO_WINT = 0, DO_WMT = 20 * MiB, DO_WAT = 22 * MiB, DO_GATES = 24 * MiB, DO_ROPE = 26 * MiB, DO_PREA = 27 * MiB, DO_PREV = 28 * MiB, DO_PREC = 29 * MiB,
                 DO_CHS = 30 * MiB, DO_NLOC = 30 * MiB + 65536, DO_MPREV = 31 * MiB;
constexpr int LDS_BYTES = 135168;

struct Params { const float* in[14]; float* out; unsigned char* ws; };

DI unsigned pk2(float lo, float hi) { unsigned r; asm volatile("v_cvt_pk_bf16_f32 %0, %1, %2" : "=v"(r) : "v"(lo), "v"(hi)); return r; }
DI float bflo(unsigned w) { return __uint_as_float(w << 16); }
DI float bfhi(unsigned w) { return __uint_as_float(w & 0xffff0000u); }
DI int opaque_tid() { int t = threadIdx.x; asm volatile("" : "+v"(t)); return t; }
DI float wave_sum(float v) {
#pragma unroll
    for (int o = 1; o < 64; o <<= 1) v += __shfl_xor(v, o);
    return v;
}
DI float sigm(float x) { return 1.f / (1.f + __expf(-x)); }
DI float silu(float x) { return x / (1.f + __expf(-x)); }
DI float logsig(float x) { return fminf(x, 0.f) - log1pf(expf(-fabsf(x))); }
DI int crow(int r, int hi) { return (r & 3) + 8 * (r >> 2) + 4 * hi; }
#define LDS_WAIT() asm volatile("s_waitcnt lgkmcnt(0)" ::: "memory")
#define SBAR() __builtin_amdgcn_sched_barrier(0)
#define KSWZ(row, colB) ((row) * 256 + ((colB) ^ (((row) & 7) << 4)))

DI int v_st(int k, int c) { const int kk = (k & ~0xC) | ((k & 4) << 1) | ((k & 8) >> 1); return ((kk >> 3) * 4 + (c >> 5)) * 512 + ((kk & 7) * 32 + (c & 31)) * 2; }
DI int v_rd_base(int lane) { return ((lane & 3) << 3) | (((lane >> 2) & 3) << 6) | (((lane >> 4) & 1) << 5) | (((lane >> 5) & 1) << 8); }
constexpr int v_rd_off(int d0, int ks, int half) { return d0 * 512 + ks * 4096 + half * 2048; }
template <int OFF> DI s16x4 tr_read(int vb) { s16x4 r; asm volatile("ds_read_b64_tr_b16 %0, %1 offset:%2" : "=&v"(r) : "v"(vb), "i"(OFF) : "memory"); return r; }
#define PKV(L, H) (bf16x8){L[0], L[1], L[2], L[3], H[0], H[1], H[2], H[3]}
#define MFMA32(a, b, c) __builtin_amdgcn_mfma_f32_32x32x16_bf16((a), (b), (c), 0, 0, 0)

namespace pg8 {
#define PG8_LAS __attribute__((address_space(3)))
typedef unsigned short bf16_t;
typedef short bf16x8 __attribute__((ext_vector_type(8)));
typedef float f32x4 __attribute__((ext_vector_type(4)));
typedef unsigned u32x4 __attribute__((ext_vector_type(4)));
constexpr int BM = 256, BK = 64, HALF = 128, HTB = HALF * BK * 2  , STAGE_BYTES = 8 * HTB, NXCD = 8, WGM = 8;

__host__ __device__ __forceinline__ int lds_byte(int r, int c) { const int st = (r >> 4) * 2 + (c >> 5), rr = r & 15, cc = c & 31, ob = rr * 64 + cc * 2; return st * 1024 + (ob ^ (((ob >> 9) & 1) << 5)); }
__host__ __device__ __forceinline__ void stage_rc(int b, int& R, int& C) { const int st = b / 1024, sb = b % 1024, swz = sb ^ (((sb >> 9) & 1) << 5); R = (st >> 1) * 16 + swz / 64; C = (st & 1) * 32 + (swz % 64) / 2; }
__host__ __device__ __forceinline__ int perm32(int rho) { const int n = rho >> 4, i = rho & 15; return 8 * (i >> 2) + 4 * n + (i & 3); }

struct Unit { int pm, pn; };
struct Gemm { const bf16_t* A; const bf16_t* Bt; int M, N, K; };

struct StaticOrder {
    int nM, nN, nwg, G, c;
    __host__ __device__ void init(int M, int N, int G_, int c_) { nM = M / BM; nN = N / BM; nwg = nM * nN; G = G_; c = c_; }
    __host__ __device__ bool next(int i, Unit& u) const {
        const long L = (long)i * G + c; if (L >= nwg) return false;
        int wgid = (int)L; { const int q = nwg / NXCD, r = nwg % NXCD, xcd = wgid % NXCD, off = wgid / NXCD; wgid = (xcd < r ? xcd * (q + 1) : r * (q + 1) + (xcd - r) * q) + off; }
        const int nig = WGM * nN, gid = wgid / nig, fm = gid * WGM, gsz = (nM - fm) < WGM ? (nM - fm) : WGM;
        u.pm = fm + ((wgid % nig) % gsz); u.pn = (wgid % nig) / gsz; return true;
    }
    __device__ __forceinline__ void a_ready(const Unit&) const {}
    __device__ __forceinline__ void done(const Unit&) const {}
};
template <class Epi, class Sched>
__device__ __forceinline__ void gemm_phase(PG8_LAS unsigned char* lds, const Gemm g, const Sched& S, const Epi& E) {
    const int tid = opaque_tid(), wid = __builtin_amdgcn_readfirstlane(tid >> 6), lane = tid & 63, wr = wid >> 2, wc = wid & 3, fr = lane & 15, fq = lane >> 4;
    const int K = g.K, nt = K / BK;
    unsigned voffA[2], voffB[2];
#pragma unroll
    for (int i = 0; i < 2; ++i) { int R, C; stage_rc(tid * 16 + i * 8192, R, C); const int Rb = Epi::PERM ? ((R & ~31) + perm32(R & 31)) : R;
        voffA[i] = (unsigned)(R * K + C) * 2u; voffB[i] = (unsigned)(Rb * K + C) * 2u; }
    const size_t kstep = (size_t)(BK * 2);
    const size_t hstep = (size_t)HALF * K * 2;
    const size_t tstep = 2 * hstep;
    const unsigned ldsw = (unsigned)wid * 1024u;
    const int aoff = lds_byte(wr * 64 + fr, fq * 8), boff = lds_byte(wc * 32 + fr, fq * 8);
#define PG8_SA(b, h) (((b) * 2 + (h)) * HTB)
#define PG8_SB(b, h) ((4 + (b) * 2 + (h)) * HTB)
#define PG8_STAGE(bufoff, gbase, voff) do { _Pragma("unroll") for (int _i = 0; _i < 2; ++_i) \
        __builtin_amdgcn_global_load_lds((const unsigned*)((const char*)(gbase) + (voff)[_i]), (PG8_LAS unsigned*)(lds + (bufoff) + ldsw + _i * 8192), 16, 0, 0); } while (0)
#define PG8_LDA(dst, b, h) do { _Pragma("unroll") for (int m = 0; m < 4; ++m) _Pragma("unroll") for (int k = 0; k < 2; ++k) dst[m][k] = *(const PG8_LAS bf16x8*)(lds + PG8_SA(b, h) + aoff + m * 2048 + k * 1024); } while (0)
#define PG8_LDB(dst, b, h) do { _Pragma("unroll") for (int n = 0; n < 2; ++n) _Pragma("unroll") for (int k = 0; k < 2; ++k) dst[n][k] = *(const PG8_LAS bf16x8*)(lds + PG8_SB(b, h) + boff + n * 2048 + k * 1024); } while (0)
#define PG8_MMA(ai, bj, At, Bt) do { __builtin_amdgcn_s_setprio(1); _Pragma("unroll") for (int m = 0; m < 4; ++m) _Pragma("unroll") for (int n = 0; n < 2; ++n) _Pragma("unroll") for (int k = 0; k < 2; ++k) \
        acc[ai][bj][m][n] = __builtin_amdgcn_mfma_f32_16x16x32_bf16(Bt[n][k], At[m][k], acc[ai][bj][m][n], 0, 0, 0); __builtin_amdgcn_s_setprio(0); } while (0)
#define PG8_WAIT_V(n) asm volatile("s_waitcnt vmcnt(" #n ")" ::: "memory")
#define PG8_WAIT_L(n) asm volatile("s_waitcnt lgkmcnt(" #n ")" ::: "memory")
#define PG8_BAR __builtin_amdgcn_s_barrier()
#define PG8_SCHED __builtin_amdgcn_sched_barrier(0)
    Unit cur, nxt; int ui = 0;
    if (!S.next(0, cur)) return;
    f32x4 acc[2][2][4][2];
#pragma unroll
    for (int a = 0; a < 2; ++a)
#pragma unroll
        for (int b = 0; b < 2; ++b)
#pragma unroll
            for (int m = 0; m < 4; ++m)
#pragma unroll
                for (int n = 0; n < 2; ++n) acc[a][b][m][n] = (f32x4){0.f, 0.f, 0.f, 0.f};
    bf16x8 At[4][2], B0[2][2], B1[2][2];
    const char* cA = (const char*)g.A + (size_t)cur.pm * tstep; const char* cB = (const char*)g.Bt + (size_t)cur.pn * tstep;
    S.a_ready(cur);
    PG8_STAGE(PG8_SB(0, 0), cB, voffB); PG8_STAGE(PG8_SA(0, 0), cA, voffA); PG8_STAGE(PG8_SB(0, 1), cB + hstep, voffB); PG8_STAGE(PG8_SA(0, 1), cA + hstep, voffA);
    if (wr == 1) PG8_BAR;
    PG8_WAIT_V(4); PG8_BAR;
    PG8_STAGE(PG8_SB(1, 0), cB + kstep, voffB); PG8_STAGE(PG8_SA(1, 0), cA + kstep, voffA); PG8_STAGE(PG8_SB(1, 1), cB + hstep + kstep, voffB);
    PG8_WAIT_V(6); PG8_BAR;
    for (;;) {
        const bool has_next = S.next(ui + 1, nxt);
        const char* nA = has_next ? (const char*)g.A + (size_t)nxt.pm * tstep : cA; const char* nB = has_next ? (const char*)g.Bt + (size_t)nxt.pn * tstep : cB;
        for (int t = 0; t < nt; t += 2) {
            const bool last = (t == nt - 2);
            const char* a1 = cA + (size_t)(t + 1) * kstep;
            const char* a2 = last ? nA : cA + (size_t)(t + 2) * kstep; const char* b2 = last ? nB : cB + (size_t)(t + 2) * kstep;
            const char* a3 = a2 + kstep; const char* b3 = b2 + kstep;
            if (last && has_next) S.a_ready(nxt);
            PG8_LDB(B0, 0, 0); PG8_SCHED; PG8_LDA(At, 0, 0); PG8_STAGE(PG8_SA(1, 1), a1 + hstep, voffA);
            PG8_WAIT_L(8); PG8_BAR; PG8_WAIT_L(0); PG8_MMA(0, 0, At, B0); PG8_BAR; PG8_SCHED;
            PG8_LDB(B1, 0, 1); PG8_STAGE(PG8_SB(0, 0), b2, voffB);
            PG8_BAR; PG8_WAIT_L(0); PG8_MMA(0, 1, At, B1); PG8_BAR;
            PG8_LDA(At, 0, 1); PG8_STAGE(PG8_SA(0, 0), a2, voffA);
            PG8_BAR; PG8_WAIT_L(0); PG8_MMA(1, 0, At, B0); PG8_BAR; PG8_SCHED;
            PG8_STAGE(PG8_SB(0, 1), b2 + hstep, voffB);
            PG8_WAIT_V(6); PG8_BAR; PG8_MMA(1, 1, At, B1); PG8_BAR;
            PG8_LDB(B0, 1, 0); PG8_SCHED; PG8_LDA(At, 1, 0); PG8_STAGE(PG8_SA(0, 1), a2 + hstep, voffA);
            PG8_WAIT_L(8); PG8_BAR; PG8_WAIT_L(0); PG8_MMA(0, 0, At, B0); PG8_BAR; PG8_SCHED;
            PG8_LDB(B1, 1, 1); PG8_STAGE(PG8_SB(1, 0), b3, voffB);
            PG8_BAR; PG8_WAIT_L(0); PG8_MMA(0, 1, At, B1); PG8_BAR;
            PG8_LDA(At, 1, 1); PG8_STAGE(PG8_SA(1, 0), a3, voffA);
            PG8_BAR; PG8_WAIT_L(0); PG8_MMA(1, 0, At, B0); PG8_BAR; PG8_SCHED;
            PG8_STAGE(PG8_SB(1, 1), b3 + hstep, voffB);
            PG8_WAIT_V(6); PG8_BAR; PG8_MMA(1, 1, At, B1); PG8_BAR;
        }
        if constexpr (!Epi::AFTER_DRAIN) { E(acc, cur, wr, wc, fr, fq); S.done(cur); }
        if (!has_next) break;
#pragma unroll
        for (int a = 0; a < 2; ++a)
#pragma unroll
            for (int b = 0; b < 2; ++b)
#pragma unroll
                for (int m = 0; m < 4; ++m)
#pragma unroll
                    for (int n = 0; n < 2; ++n) acc[a][b][m][n] = (f32x4){0.f, 0.f, 0.f, 0.f};
        cur = nxt; cA = nA; cB = nB; ++ui;
    }
    PG8_WAIT_V(0);
    if (wr == 0) PG8_BAR;
    PG8_BAR;
    if constexpr (Epi::AFTER_DRAIN) { E.fused(acc, cur, wr, wc, fr, fq, lds, wid, lane); S.done(cur); }
#undef PG8_SA
#undef PG8_SB
#undef PG8_STAGE
#undef PG8_LDA
#undef PG8_LDB
#undef PG8_MMA
#undef PG8_WAIT_V
#undef PG8_WAIT_L
#undef PG8_BAR
#undef PG8_SCHED
}
}

DI u32x4 pack8(const f32x4 a, const f32x4 b) { u32x4 w; w.x = pk2(a[0], a[1]); w.y = pk2(a[2], a[3]); w.z = pk2(b[0], b[1]); w.w = pk2(b[2], b[3]); return w; }

struct EpiProj {
    static constexpr bool PERM = true, AFTER_DRAIN = false;
    unsigned char* ws; const float* rope; const float* bmerge; int tile0;
    DI void operator()(const f32x4 (&acc)[2][2][4][2], const pg8::Unit& u, int wr, int wc, int fr, int fq) const {
        const int gt = tile0 + u.pn, row0 = u.pm * 256 + wr * 64 + fr, c8 = wc * 32 + 8 * fq;
        if (gt >= 8 && gt < 16) {
            bf16_t* O = (bf16_t*)(ws + WS_OG);
#pragma unroll
            for (int ai = 0; ai < 2; ++ai)
#pragma unroll
                for (int m = 0; m < 4; ++m) { const int row = row0 + ai * 128 + m * 16; f32x4 r0, r1;
#pragma unroll
                    for (int e = 0; e < 4; ++e) { r0[e] = sigm(acc[ai][0][m][0][e]) * silu(acc[ai][1][m][0][e]); r1[e] = sigm(acc[ai][0][m][1][e]) * silu(acc[ai][1][m][1][e]); }
                    *(u32x4*)(O + (size_t)row * 1024 + (gt - 8) * 128 + c8) = pack8(r0, r1); }
            return;
        }
        if (gt >= 16 && gt < 24) {
            bf16_t* O = (bf16_t*)(ws + (gt < 20 ? WS_AQ : WS_AK)); const int ct = (gt & 3) * 256;
            const bool rot = ((wc & 1) == 0);
#pragma unroll
            for (int ai = 0; ai < 2; ++ai)
#pragma unroll
                for (int m = 0; m < 4; ++m) { const int row = row0 + ai * 128 + m * 16;
#pragma unroll
                    for (int bj = 0; bj < 2; ++bj) { f32x4 v0 = acc[ai][bj][m][0], v1 = acc[ai][bj][m][1];
                        if (rot) {
                            const float* rp = rope + (size_t)(row & (SEQ - 1)) * 16;
                            const f32x4 cs0 = *(const f32x4*)(rp), cs1 = *(const f32x4*)(rp + 4), sn0 = *(const f32x4*)(rp + 8), sn1 = *(const f32x4*)(rp + 12);
                            f32x4 p0, p1;
#pragma unroll
                            for (int e = 0; e < 4; ++e) { p0[e] = __shfl_xor(v0[e], 16); p1[e] = __shfl_xor(v1[e], 16); }
                            const float sg = (fq == 0) ? -1.f : 1.f;
                            if (fq < 2) {
#pragma unroll
                                for (int e = 0; e < 4; ++e) { v0[e] = v0[e] * cs0[e] + sg * p0[e] * sn0[e]; v1[e] = v1[e] * cs1[e] + sg * p1[e] * sn1[e]; }
                            }
                        }
                        *(u32x4*)(O + (size_t)row * 1024 + ct + bj * 128 + c8) = pack8(v0, v1); } }
            return;
        }
        if (gt >= 32) {
            bf16_t* O = (bf16_t*)(ws + WS_G); const int ct = (gt - 32) * 256;
#pragma unroll
            for (int bj = 0; bj < 2; ++bj) { const f32x4 b0 = *(const f32x4*)(bmerge + ct + bj * 128 + c8), b1 = *(const f32x4*)(bmerge + ct + bj * 128 + c8 + 4);
#pragma unroll
                for (int ai = 0; ai < 2; ++ai)
#pragma unroll
                    for (int m = 0; m < 4; ++m) { const int row = row0 + ai * 128 + m * 16; f32x4 r0, r1;
#pragma unroll
                        for (int e = 0; e < 4; ++e) { r0[e] = sigm(acc[ai][bj][m][0][e] + b0[e]); r1[e] = sigm(acc[ai][bj][m][1][e] + b1[e]); }
                        *(u32x4*)(O + (size_t)row * 2048 + ct + bj * 128 + c8) = pack8(r0, r1); } }
            return;
        }
        {
            const size_t off = gt < 4 ? WS_MQK : (gt < 8 ? WS_MV : (gt < 28 ? WS_AV : WS_AZ));
            bf16_t* O = (bf16_t*)(ws + off); const int ct = (gt & 3) * 256; const bool act = gt >= 28;
#pragma unroll
            for (int ai = 0; ai < 2; ++ai)
#pragma unroll
                for (int m = 0; m < 4; ++m) { const int row = row0 + ai * 128 + m * 16;
#pragma unroll
                    for (int bj = 0; bj < 2; ++bj) { f32x4 v0 = acc[ai][bj][m][0], v1 = acc[ai][bj][m][1];
                        if (act) {
#pragma unroll
                            for (int e = 0; e < 4; ++e) { v0[e] = silu(v0[e]); v1[e] = silu(v1[e]); } }
                        *(u32x4*)(O + (size_t)row * 1024 + ct + bj * 128 + c8) = pack8(v0, v1); } }
        }
    }
};

struct F1Order {
    int G, c;
    DI bool next(int i, pg8::Unit& u) const { const int tile = (i >> 1) * G + c; if (tile >= 512) return false; const int m = tile >> 2, n = tile & 3;
        if (i & 1) { u.pm = 128 + m; u.pn = 4 + n; } else { u.pm = m; u.pn = n; } return true; }
    DI void a_ready(const pg8::Unit&) const {}
    DI void done(const pg8::Unit&) const {}
};
struct EpiY {
    static constexpr bool PERM = true, AFTER_DRAIN = false;
    const bf16_t* G; bf16_t* Y;
    DI void operator()(const f32x4 (&acc)[2][2][4][2], const pg8::Unit& u, int wr, int wc, int fr, int fq) const {
        const int sub = u.pm >= 128 ? 1 : 0, row0 = (u.pm & 127) * 256 + wr * 64 + fr, c0 = (u.pn & 3) * 256 + wc * 32 + 8 * fq;
#pragma unroll
        for (int ai = 0; ai < 2; ++ai)
#pragma unroll
            for (int m = 0; m < 4; ++m) { const int row = row0 + ai * 128 + m * 16;
#pragma unroll
                for (int bj = 0; bj < 2; ++bj) { const int col = c0 + bj * 128;
                    const u32x4 gw = *(const u32x4*)(G + (size_t)row * 2048 + sub * 1024 + col);
                    const f32x4 v0 = acc[ai][bj][m][0], v1 = acc[ai][bj][m][1]; f32x4 r0, r1;
                    r0[0] = bflo(gw.x) * v0[0]; r0[1] = bfhi(gw.x) * v0[1]; r0[2] = bflo(gw.y) * v0[2]; r0[3] = bfhi(gw.y) * v0[3];
                    r1[0] = bflo(gw.z) * v1[0]; r1[1] = bfhi(gw.z) * v1[1]; r1[2] = bflo(gw.w) * v1[2]; r1[3] = bfhi(gw.w) * v1[3];
                    bf16_t* yp = Y + (size_t)row * 1024 + col;
                    if (sub) { const u32x4 yo = *(const u32x4*)yp;
                        r0[0] += bflo(yo.x); r0[1] += bfhi(yo.x); r0[2] += bflo(yo.y); r0[3] += bfhi(yo.y); r1[0] += bflo(yo.z); r1[1] += bfhi(yo.z); r1[2] += bflo(yo.w); r1[3] += bfhi(yo.w); }
                    *(u32x4*)yp = pack8(r0, r1); } }
    }
};
struct EpiOut {
    static constexpr bool PERM = false, AFTER_DRAIN = false;
    float* C; float* rowsq;
    DI void operator()(const f32x4 (&acc)[2][2][4][2], const pg8::Unit& u, int wr, int wc, int fr, int fq) const {
        const int row0 = u.pm * 256 + wr * 64 + fr, col0 = u.pn * 256 + wc * 32 + 4 * fq;
#pragma unroll
        for (int ai = 0; ai < 2; ++ai)
#pragma unroll
            for (int m = 0; m < 4; ++m) { const int row = row0 + ai * 128 + m * 16; float* rowp = C + (size_t)row * 1024 + col0; float s = 0.f;
#pragma unroll
                for (int bj = 0; bj < 2; ++bj)
#pragma unroll
                    for (int n = 0; n < 2; ++n) { const f32x4 v = acc[ai][bj][m][n]; *(f32x4*)(rowp + bj * 128 + n * 16) = v; s += (v[0] * v[0] + v[1] * v[1]) + (v[2] * v[2] + v[3] * v[3]); }
                s += __shfl_xor(s, 16); s += __shfl_xor(s, 32);
                if (fq == 0) rowsq[(size_t)row * 16 + u.pn * 4 + wc] = s; }
    }
};

DI int win_src_col(int np) {
    if (np < 2048) return np;
    if (np < 4096) { const int i = (np - 2048) >> 8, c = (np - 2048) & 255; return c < 128 ? 2064 + 128 * i + c : 3088 + 128 * i + (c - 128); }
    return np + 16;
}
DI void transpose_item(const float* __restrict__ W, int ldw, int nsrc, int k0, bf16_t* __restrict__ WT, int ndst, int K, float* scr, int lane) {
#pragma unroll 8
    for (int i = 0; i < 32; ++i) { const int kk = 2 * i + (lane >> 5); scr[kk * 33 + (lane & 31)] = W[(size_t)(k0 + kk) * ldw + nsrc + (lane & 31)]; }
    LDS_WAIT();
    const int c = lane & 7;
#pragma unroll
    for (int j = 0; j < 4; ++j) { const int n = (lane >> 3) + 8 * j; const float* s = scr + (8 * c) * 33 + n;
        u32x4 o; o.x = pk2(s[0 * 33], s[1 * 33]); o.y = pk2(s[2 * 33], s[3 * 33]); o.z = pk2(s[4 * 33], s[5 * 33]); o.w = pk2(s[6 * 33], s[7 * 33]);
        *(u32x4*)(WT + (size_t)(ndst + n) * K + k0 + 8 * c) = o; }
    LDS_WAIT();
}
__device__ const float ROPE_INV[8] = {1.0f, 0.19392274f, 0.037606031f, 0.0072926646f, 0.0014142136f, 0.00027424819f, 5.3182957e-05f, 1.0313385e-05f};

DI void phase_prep(const Params& P, unsigned char* lds) {
    const int tid = opaque_tid(), lane = tid & 63, wave = __builtin_amdgcn_readfirstlane(tid >> 6), G = gridDim.x, gw = blockIdx.x * 8 + wave, NGW = G * 8;
    unsigned char* dsc = (unsigned char*)P.out;
    { float* scr = (float*)(lds + wave * 8448);
      bf16_t* WinT = (bf16_t*)(dsc + DO_WINT); bf16_t* WmT = (bf16_t*)(dsc + DO_WMT); bf16_t* WaT = (bf16_t*)(dsc + DO_WAT);
      constexpr int I_IN = 16 * 320, I_B = 16 * 32;
      for (int it = gw; it < I_IN + 2 * I_B; it += NGW) {
          if (it < I_IN) { const int kb = it / 320, nb = it % 320; transpose_item(P.in[2], 10256, win_src_col(nb * 32), kb * 64, WinT, nb * 32, 1024, scr, lane); }
          else if (it < I_IN + I_B) { const int r = it - I_IN, kb = r >> 5, nb = r & 31; transpose_item(P.in[9], 1024, nb * 32, kb * 64, WmT, nb * 32, 1024, scr, lane); }
          else { const int r = it - I_IN - I_B, kb = r >> 5, nb = r & 31; transpose_item(P.in[10], 1024, nb * 32, kb * 64, WaT, nb * 32, 1024, scr, lane); }
      } }
    { float* rope = (float*)(dsc + DO_ROPE);
      for (int i = blockIdx.x * 512 + tid; i < SEQ * 8; i += G * 512) { const int pos = i >> 3, j = i & 7; const float ang = (float)pos * ROPE_INV[j];
          rope[pos * 16 + j] = cosf(ang); rope[pos * 16 + 8 + j] = sinf(ang); } }
    __syncthreads();
    { const float* Win = P.in[2];
      for (int i = tid; i < 4096; i += 512) { const int c = i >> 2, k4 = i & 3; const f32x4 v = *(const f32x4*)(Win + (size_t)c * 10256 + 2048 + 4 * k4);
          *(f32x4*)(lds + ((size_t)(k4 * 1024 + (c & 3) * 256 + (c >> 2)) * 16)) = v; } }
    __syncthreads();
    { const float* x = P.in[0]; const float* g = P.in[1]; const float* gb = P.in[5];
      bf16_t* XN = (bf16_t*)(P.ws + WS_XN); float* GT = (float*)(dsc + DO_GATES);
      f32x4 gv[4];
#pragma unroll
      for (int j = 0; j < 4; ++j) gv[j] = *(const f32x4*)(g + 4 * lane + 256 * j);
      const float gbias = gb[lane & 15];
      for (int row = gw; row < T; row += NGW) {
          const f32x4* xr = (const f32x4*)(x + (size_t)row * 1024) + lane;
          f32x4 v[4]; float ss = 0.f;
#pragma unroll
          for (int j = 0; j < 4; ++j) { v[j] = xr[64 * j]; ss += (v[j][0] * v[j][0] + v[j][1] * v[j][1]) + (v[j][2] * v[j][2] + v[j][3] * v[j][3]); }
          const float rstd = 1.f / sqrtf(wave_sum(ss) * (1.f / 1024.f) + EPS);
          unsigned long long* o8 = (unsigned long long*)(XN + (size_t)row * 1024) + lane;
          float ga[16];
#pragma unroll
          for (int k = 0; k < 16; ++k) ga[k] = 0.f;
#pragma unroll
          for (int j = 0; j < 4; ++j) {
#pragma unroll
              for (int e = 0; e < 4; ++e) v[j][e] = v[j][e] * rstd * gv[j][e];
              o8[64 * j] = (unsigned long long)pk2(v[j][0], v[j][1]) | ((unsigned long long)pk2(v[j][2], v[j][3]) << 32);
#pragma unroll
              for (int e = 0; e < 4; ++e) {
                  const float xv = v[j][e];
#pragma unroll
                  for (int k4 = 0; k4 < 4; ++k4) { const f32x4 w = *(const f32x4*)(lds + ((size_t)(k4 * 1024 + e * 256 + lane + 64 * j) * 16));
                      ga[4 * k4 + 0] += xv * w[0]; ga[4 * k4 + 1] += xv * w[1]; ga[4 * k4 + 2] += xv * w[2]; ga[4 * k4 + 3] += xv * w[3]; } } }
          float mine = 0.f;
#pragma unroll
          for (int k = 0; k < 16; ++k) { const float s = wave_sum(ga[k]); mine = ((lane & 15) == k) ? s : mine; }
          if (lane < 16) { float val = mine + gbias; if ((lane >> 2) & 1) val = logsig(val); GT[(size_t)row * 16 + lane] = val; }
      } }
}
DI void phase_final(const Params& P) {
    const int tid = opaque_tid(), lane = tid & 63, wave = __builtin_amdgcn_readfirstlane(tid >> 6), gw = blockIdx.x * 8 + wave, NGW = gridDim.x * 8;
    const float* x = P.in[0]; const float* pg = P.in[13]; const float* rowsq = (const float*)(P.ws + WS_ROWSQ);
    f32x4 gv[4];
#pragma unroll
    for (int j = 0; j < 4; ++j) gv[j] = *(const f32x4*)(pg + 4 * lane + 256 * j);
    for (int row = gw; row < T; row += NGW) {
        const float part = (lane < 16) ? rowsq[(size_t)row * 16 + lane] : 0.f;
        const float rstd = 1.f / sqrtf(wave_sum(part) * (1.f / 1024.f) + EPS);
        const f32x4* xr = (const f32x4*)(x + (size_t)row * 1024) + lane; f32x4* orow = (f32x4*)(P.out + (size_t)row * 1024) + lane;
#pragma unroll
        for (int j = 0; j < 4; ++j) { const f32x4 o = orow[64 * j], xv = xr[64 * j]; f32x4 r;
#pragma unroll
            for (int e = 0; e < 4; ++e) r[e] = xv[e] + o[e] * rstd * gv[j][e];
            orow[64 * j] = r; }
    }
}
DI void prep_wout(const Params& P, unsigned char* lds) {
    const int tid = opaque_tid(), lane = tid & 63, wave = __builtin_amdgcn_readfirstlane(tid >> 6), gw = blockIdx.x * 8 + wave, NGW = gridDim.x * 8;
    float* scr = (float*)(lds + wave * 8448); bf16_t* WoT = (bf16_t*)(P.ws + WS_WOT);
    for (int it = gw; it < 512; it += NGW) { const int kb = it >> 5, nb = it & 31; transpose_item(P.in[12], 1024, nb * 32, kb * 64, WoT, nb * 32, 1024, scr, lane); }
}

namespace att {
constexpr int KVBLK = 64;
constexpr float SCALE = 0.125f, THR = 8.f;
constexpr int SHM_V = KVBLK * 128 * 2, SHM_K = KVBLK * 128 * 2;
constexpr int WSOFF = 98304;
constexpr int XS = 132;

DI void partialSM(f32x16& p0, f32x16& p1, float& m_reg, float& mn, float& alpha) {
    constexpr float C = SCALE * 1.4426950408889634f;
    float pmax = p0[0];
#pragma unroll
    for (int r = 1; r < 16; ++r) pmax = fmaxf(pmax, p0[r]);
#pragma unroll
    for (int r = 0; r < 16; ++r) pmax = fmaxf(pmax, p1[r]);
    { auto rr = __builtin_amdgcn_permlane32_swap(__float_as_uint(pmax), __float_as_uint(pmax), false, false);
      pmax = fmaxf(__uint_as_float(rr[0]), __uint_as_float(rr[1])); }
    if (__builtin_expect(__all(pmax - m_reg <= THR / SCALE), 1)) { mn = m_reg; alpha = 1.f; }
    else { mn = fmaxf(m_reg, pmax); alpha = __builtin_amdgcn_exp2f((m_reg - mn) * C); m_reg = mn; }
    const float mnC = -mn * C;
#pragma unroll
    for (int r = 0; r < 16; ++r) p0[r] = fmaf(p0[r], C, mnC);
#pragma unroll
    for (int r = 0; r < 16; ++r) p1[r] = fmaf(p1[r], C, mnC);
#pragma unroll
    for (int r = 0; r < 16; ++r) p0[r] = __builtin_amdgcn_exp2f(p0[r]);
}
#define PK4(P, BASE, OUT) do { unsigned a0 = pk2(P[BASE + 0], P[BASE + 1]), a1 = pk2(P[BASE + 2], P[BASE + 3]);   \
    unsigned b0 = pk2(P[BASE + 4], P[BASE + 5]), b1 = pk2(P[BASE + 6], P[BASE + 7]);                              \
    auto r0 = __builtin_amdgcn_permlane32_swap(a0, b0, false, false); auto r1 = __builtin_amdgcn_permlane32_swap(a1, b1, false, false); \
    u32x4 w = {r0[0], r1[0], r0[1], r1[1]}; OUT = *reinterpret_cast<bf16x8*>(&w); } while (0)
DI void finishSM(f32x16& p0, f32x16& p1, float alpha, float& l_reg, bf16x8& pa0, bf16x8& pa1, bf16x8& pa2, bf16x8& pa3) {
#pragma unroll
    for (int r = 0; r < 16; ++r) p1[r] = __builtin_amdgcn_exp2f(p1[r]);
    float ps = 0;
#pragma unroll
    for (int r = 0; r < 16; ++r) ps += p0[r];
#pragma unroll
    for (int r = 0; r < 16; ++r) ps += p1[r];
    { auto rr = __builtin_amdgcn_permlane32_swap(__float_as_uint(ps), __float_as_uint(ps), false, false);
      ps = __uint_as_float(rr[0]) + __uint_as_float(rr[1]); }
    l_reg = l_reg * alpha + ps;
    PK4(p0, 0, pa0); PK4(p0, 8, pa1); PK4(p1, 0, pa2); PK4(p1, 8, pa3);
}
DI void qkt(f32x16& p0, f32x16& p1, const char* Ks, const bf16x8* qr, int r32, int hi, int cbase) {
    p0 = f32x16{}; p1 = f32x16{};
#pragma unroll
    for (int d0 = 0; d0 < 4; ++d0) { const int cb = cbase + (d0 * 16 + hi * 8) * 2;
        const bf16x8 b0 = *reinterpret_cast<const bf16x8*>(Ks + KSWZ(r32, cb));
        const bf16x8 b1 = *reinterpret_cast<const bf16x8*>(Ks + KSWZ(32 + r32, cb));
        p0 = MFMA32(b0, qr[d0], p0);
        p1 = MFMA32(b1, qr[d0], p1); }
}
template <int D0> DI void pv_one(f32x16& od, int vb, bf16x8 pa0, bf16x8 pa1, bf16x8 pa2, bf16x8 pa3) {
    const s16x4 l0 = tr_read<v_rd_off(D0, 0, 0)>(vb), h0 = tr_read<v_rd_off(D0, 0, 1)>(vb), l1 = tr_read<v_rd_off(D0, 1, 0)>(vb), h1 = tr_read<v_rd_off(D0, 1, 1)>(vb);
    const s16x4 l2 = tr_read<v_rd_off(D0, 2, 0)>(vb), h2 = tr_read<v_rd_off(D0, 2, 1)>(vb), l3 = tr_read<v_rd_off(D0, 3, 0)>(vb), h3 = tr_read<v_rd_off(D0, 3, 1)>(vb);
    asm volatile("s_waitcnt lgkmcnt(0)" ::: "memory"); SBAR();
    od = MFMA32(pa0, PKV(l0, h0), od);
    od = MFMA32(pa1, PKV(l1, h1), od);
    od = MFMA32(pa2, PKV(l2, h2), od);
    od = MFMA32(pa3, PKV(l3, h3), od);
}
DI void pv_d0(f32x16* o, int vb, bf16x8 pa0, bf16x8 pa1, bf16x8 pa2, bf16x8 pa3) {
    pv_one<0>(o[0], vb, pa0, pa1, pa2, pa3); pv_one<1>(o[1], vb, pa0, pa1, pa2, pa3); pv_one<2>(o[2], vb, pa0, pa1, pa2, pa3); pv_one<3>(o[3], vb, pa0, pa1, pa2, pa3);
}

DI void attn_item(const bf16_t* __restrict__ Qb, const bf16_t* __restrict__ Kh, const bf16_t* __restrict__ Vh, bf16_t* __restrict__ AZ, const float* __restrict__ ag, float lam, char* lds) {
    constexpr int LD = 1024;
    const int tid = opaque_tid(), wid = __builtin_amdgcn_readfirstlane(tid >> 6), lane = tid & 63, r32 = lane & 31, hi = lane >> 5, comp = wid >> 2, wq = wid & 3;
    char* V_lds = lds; char* K_lds = lds + 2 * SHM_V;
    float* wsf = (float*)(lds + WSOFF) + wid * 64; float* li_l = wsf; float* al_l = wsf + 32;
    float m_reg = -1e30f, l_reg = 0; f32x16 o[4] = {}; bf16x8 qr[4];
    const bf16_t* Qw = Qb + (size_t)(wq * 32 + r32) * LD + comp * 64 + hi * 8;
#pragma unroll
    for (int d0 = 0; d0 < 4; ++d0) qr[d0] = *reinterpret_cast<const bf16x8*>(Qw + d0 * 16);
    const int cbase = comp * 128;
    const int sr = tid >> 4, sc = (tid & 15) * 8, vst0 = v_st(sr, sc), vst1 = v_st(32 + sr, sc);
    const int vb0 = (int)(uintptr_t)V_lds + v_rd_base(lane);
    struct { bf16x8 vs0, vs1, ks0, ks1; } sr_[2];
#define SLOAD(i, k0) do { sr_[i].vs0 = *reinterpret_cast<const bf16x8*>(&Vh[(size_t)((k0) + sr) * LD + sc]); sr_[i].vs1 = *reinterpret_cast<const bf16x8*>(&Vh[(size_t)((k0) + 32 + sr) * LD + sc]); \
    sr_[i].ks0 = *reinterpret_cast<const bf16x8*>(&Kh[(size_t)((k0) + sr) * LD + sc]); sr_[i].ks1 = *reinterpret_cast<const bf16x8*>(&Kh[(size_t)((k0) + 32 + sr) * LD + sc]); } while (0)
#define SWRITE(b, i) do { *(bf16x8*)(V_lds + (b) * SHM_V + vst0) = sr_[i].vs0;          \
    *(bf16x8*)(V_lds + (b) * SHM_V + vst1) = sr_[i].vs1; const int kc = sc * 2;               \
    *(bf16x8*)(K_lds + (b) * SHM_K + KSWZ(sr, kc)) = sr_[i].ks0;                       \
    *(bf16x8*)(K_lds + (b) * SHM_K + KSWZ(32 + sr, kc)) = sr_[i].ks1; } while (0)
#define SWAIT() asm volatile("s_waitcnt vmcnt(4)" ::: "memory")
#define RESC(a) do { if (__any((a) < 1.f)) { if (hi == 0) al_l[r32] = (a); asm volatile("s_waitcnt lgkmcnt(0)" ::: "memory"); \
    _Pragma("unroll") for (int d = 0; d < 4; ++d) _Pragma("unroll") for (int r = 0; r < 16; ++r) o[d][r] *= al_l[crow(r, hi)]; } } while (0)
    f32x16 pA0, pA1, pB0, pB1; float mnA, mnB, alA, alB; bf16x8 pa0, pa1, pa2, pa3; constexpr int NT = SEQ / KVBLK;
    constexpr int SE = 0, SO = 1;
    SLOAD(SE, 0); asm volatile("s_waitcnt vmcnt(0)" ::: "memory"); SWRITE(0, SE); __syncthreads();
    qkt(pA0, pA1, K_lds, qr, r32, hi, cbase); partialSM(pA0, pA1, m_reg, mnA, alA);
    SLOAD(SO, KVBLK); SLOAD(SE, 2 * KVBLK);
    SWAIT(); SWRITE(1, SO); __syncthreads();
    for (int j = 1; j + 1 < NT; j += 2) {
        SBAR(); qkt(pB0, pB1, K_lds + SHM_K, qr, r32, hi, cbase);
        finishSM(pA0, pA1, alA, l_reg, pa0, pa1, pa2, pa3); SBAR();
        SLOAD(SO, (j + 2) * KVBLK); SBAR();
        pv_d0(o, vb0, pa0, pa1, pa2, pa3); partialSM(pB0, pB1, m_reg, mnB, alB);
        __syncthreads(); SWAIT(); SWRITE(0, SE);
        RESC(alB); __syncthreads();
        SBAR(); qkt(pA0, pA1, K_lds, qr, r32, hi, cbase);
        finishSM(pB0, pB1, alB, l_reg, pa0, pa1, pa2, pa3); SBAR();
        if (j + 3 < NT) SLOAD(SE, (j + 3) * KVBLK); SBAR();
        pv_d0(o, vb0 + SHM_V, pa0, pa1, pa2, pa3); partialSM(pA0, pA1, m_reg, mnA, alA);
        __syncthreads(); SWAIT(); SWRITE(1, SO);
        RESC(alA); __syncthreads();
    }
    SBAR(); qkt(pB0, pB1, K_lds + SHM_K, qr, r32, hi, cbase);
    finishSM(pA0, pA1, alA, l_reg, pa0, pa1, pa2, pa3); SBAR();
    pv_d0(o, vb0, pa0, pa1, pa2, pa3); partialSM(pB0, pB1, m_reg, mnB, alB);
    __syncthreads(); RESC(alB);
    finishSM(pB0, pB1, alB, l_reg, pa0, pa1, pa2, pa3); SBAR();
    pv_d0(o, vb0 + SHM_V, pa0, pa1, pa2, pa3);
    if (hi == 0) li_l[r32] = l_reg; asm volatile("s_waitcnt lgkmcnt(0)" ::: "memory");
    float rli[16];
#pragma unroll
    for (int r = 0; r < 16; ++r) rli[r] = __builtin_amdgcn_rcpf(li_l[crow(r, hi)]) * (comp ? lam : 1.f);
    asm volatile("s_waitcnt vmcnt(0)" ::: "memory");
    __syncthreads();
    float* X = (float*)lds;
    if (comp == 1) {
#pragma unroll
        for (int r = 0; r < 16; ++r)
#pragma unroll
            for (int d0 = 0; d0 < 4; ++d0) X[(wq * 32 + crow(r, hi)) * XS + d0 * 32 + r32] = o[d0][r] * rli[r];
    }
    __syncthreads();
    if (comp == 0) {
#pragma unroll
        for (int r = 0; r < 16; ++r)
#pragma unroll
            for (int d0 = 0; d0 < 4; ++d0) { float* xp = &X[(wq * 32 + crow(r, hi)) * XS + d0 * 32 + r32]; *xp = o[d0][r] * rli[r] - *xp; }
    }
    __syncthreads();
    { const int row = tid >> 2, seg = tid & 3; const float* xr = X + row * XS + seg * 32; f32x4 v[8]; float ss = 0.f;
#pragma unroll
      for (int i = 0; i < 8; ++i) { v[i] = *(const f32x4*)(xr + 4 * i); ss += (v[i][0] * v[i][0] + v[i][1] * v[i][1]) + (v[i][2] * v[i][2] + v[i][3] * v[i][3]); }
      ss += __shfl_xor(ss, 1); ss += __shfl_xor(ss, 2);
      const float rstd = 0.8f / sqrtf(ss * (1.f / 128.f) + EPS);
      bf16_t* zp = AZ + (size_t)row * LD + seg * 32; const float* gp = ag + seg * 32;
#pragma unroll
      for (int i = 0; i < 4; ++i) { const u32x4 z = *(const u32x4*)(zp + 8 * i); const f32x4 g0 = *(const f32x4*)(gp + 8 * i), g1 = *(const f32x4*)(gp + 8 * i + 4);
          const f32x4 a = v[2 * i], b = v[2 * i + 1]; f32x4 r0, r1;
          r0[0] = a[0] * rstd * g0[0] * bflo(z.x); r0[1] = a[1] * rstd * g0[1] * bfhi(z.x); r0[2] = a[2] * rstd * g0[2] * bflo(z.y); r0[3] = a[3] * rstd * g0[3] * bfhi(z.y);
          r1[0] = b[0] * rstd * g1[0] * bflo(z.z); r1[1] = b[1] * rstd * g1[1] * bfhi(z.z); r1[2] = b[2] * rstd * g1[2] * bflo(z.w); r1[3] = b[3] * rstd * g1[3] * bfhi(z.w);
          *(u32x4*)(zp + 8 * i) = pack8(r0, r1); } }
    __syncthreads();
#undef SLOAD
#undef SWRITE
#undef SWAIT
#undef RESC
}
}

DI void phase_attn(const Params& P, unsigned char* lds) {
    const float* lq = P.in[7]; float s1 = 0.f, s2 = 0.f;
    for (int i = 0; i < 64; ++i) { s1 += lq[i] * lq[64 + i]; s2 += lq[128 + i] * lq[192 + i]; }
    const float lam = expf(s1) - expf(s2) + 0.2f;
    const bf16_t* AQ = (const bf16_t*)(P.ws + WS_AQ); const bf16_t* AK = (const bf16_t*)(P.ws + WS_AK); const bf16_t* AV = (const bf16_t*)(P.ws + WS_AV); bf16_t* AZ = (bf16_t*)(P.ws + WS_AZ);
    for (int it = blockIdx.x; it < 2048; it += gridDim.x) {
        const int bh = it >> 7, qb = it & 127, b = bh >> 3, h = bh & 7;
        const size_t kv0 = (size_t)b * SEQ * 1024 + h * 128, q0 = ((size_t)b * SEQ + qb * 128) * 1024 + h * 128;
        att::attn_item(AQ + q0, AK + kv0, AV + kv0, AZ + q0, P.in[8], lam, (char*)lds);
    }
}

namespace ml {
DI float wave_incl_add(float x, int lane) {
#pragma unroll
    for (int o = 1; o < 64; o <<= 1) { const float y = __shfl_up(x, o); if (lane >= o) x += y; } return x; }
DI float wave_incl_max(float x, int lane) {
#pragma unroll
    for (int o = 1; o < 64; o <<= 1) { const float y = __shfl_up(x, o); if (lane >= o) x = fmaxf(x, y); } return x; }
DI float wave_suf_add(float x, int lane) {
#pragma unroll
    for (int o = 1; o < 64; o <<= 1) { const float y = __shfl_down(x, o); if (lane + o < 64) x += y; } return x; }
DI float wave_suf_max(float x, int lane) {
#pragma unroll
    for (int o = 1; o < 64; o <<= 1) { const float y = __shfl_down(x, o); if (lane + o < 64) x = fmaxf(x, y); } return x; }

DI void conv8(const bf16_t* __restrict__ src, int pos, const float* conv_w, const float* conv_b, int ch, float (&out)[8]) {
    const float* wp = conv_w + ch; const float* bp = conv_b + ch;
    asm volatile("" : "+v"(wp), "+v"(bp));
    { const f32x4 a = *(const f32x4*)bp, b = *(const f32x4*)(bp + 4);
      out[0] = a[0]; out[1] = a[1]; out[2] = a[2]; out[3] = a[3]; out[4] = b[0]; out[5] = b[1]; out[6] = b[2]; out[7] = b[3]; }
#pragma unroll
    for (int j = 0; j < 4; ++j) { const int p = pos + j - 2;
        if (p >= 0 && p < SEQ) { const u32x4 w = *(const u32x4*)(src + (ptrdiff_t)(j - 2) * 1024);
            const f32x4 a = *(const f32x4*)(wp + j * 1024), b = *(const f32x4*)(wp + j * 1024 + 4);
            out[0] += a[0] * bflo(w.x); out[1] += a[1] * bfhi(w.x); out[2] += a[2] * bflo(w.y); out[3] += a[3] * bfhi(w.y);
            out[4] += b[0] * bflo(w.z); out[5] += b[1] * bfhi(w.z); out[6] += b[2] * bflo(w.w); out[7] += b[3] * bfhi(w.w); } }
#pragma unroll
    for (int e = 0; e < 8; ++e) out[e] = silu(out[e]);
}
DI u32x4 pack8f(const float (&v)[8], float s) { u32x4 w; w.x = pk2(v[0] * s, v[1] * s); w.y = pk2(v[2] * s, v[3] * s); w.z = pk2(v[4] * s, v[5] * s); w.w = pk2(v[6] * s, v[7] * s); return w; }

DI void m1_item(const Params& P, unsigned char* lds, int item) {
    const int tid = opaque_tid(), wid = __builtin_amdgcn_readfirstlane(tid >> 6), lane = tid & 63, r32 = lane & 31, hi = lane >> 5;
    const int b = item >> 8, h = (item >> 6) & 3, c = item & 63;
    unsigned char* dsc = (unsigned char*)P.out;
    const float* GT = (const float*)(dsc + DO_GATES);
    float* PREA = (float*)(dsc + DO_PREA); float* PREV = (float*)(dsc + DO_PREV); float* PREC = (float*)(dsc + DO_PREC);
    float* CHS = (float*)(dsc + DO_CHS); float* NLOC = (float*)(dsc + DO_NLOC);
    const bf16_t* MQK = (const bf16_t*)(P.ws + WS_MQK); const bf16_t* MV = (const bf16_t*)(P.ws + WS_MV); bf16_t* ST = (bf16_t*)(P.ws + WS_ST);
    float* gI = (float*)(lds + 65536);
    float* gL = gI + 512;
    float* wk = gL + 512;
    float* nacc = wk + 512;
    const size_t tok0 = (size_t)b * SEQ + c * 256;
    if (tid < 256) { const float* gp = GT + (tok0 + tid) * 16 + h; gI[tid] = gp[0]; gL[tid] = gp[4]; gI[256 + tid] = gp[8]; gL[256 + tid] = gp[12]; nacc[tid] = 0.f; }
    __syncthreads();
    if (wid < 2) {
        const int dir = wid, seq = (dir * 2 + b) * 4 + h; const float* li = gI + dir * 256; const float* ll = gL + dir * 256;
        float lf[4], ig[4], a[4], v[4], cm[4];
#pragma unroll
        for (int k = 0; k < 4; ++k) { lf[k] = ll[4 * lane + k]; ig[k] = li[4 * lane + k]; }
        float A, vmax;
        if (dir == 0) {
            a[0] = lf[0]; a[1] = a[0] + lf[1]; a[2] = a[1] + lf[2]; a[3] = a[2] + lf[3];
            const float ex = wave_incl_add(a[3], lane) - a[3];
#pragma unroll
            for (int k = 0; k < 4; ++k) { a[k] += ex; v[k] = ig[k] - a[k]; }
            cm[0] = v[0]; cm[1] = fmaxf(cm[0], v[1]); cm[2] = fmaxf(cm[1], v[2]); cm[3] = fmaxf(cm[2], v[3]);
            const float inc = wave_incl_max(cm[3], lane); float exm = __shfl_up(inc, 1); if (lane == 0) exm = -3.0e38f;
#pragma unroll
            for (int k = 0; k < 4; ++k) cm[k] = fmaxf(cm[k], exm);
            A = __shfl(a[3], 63); vmax = __shfl(cm[3], 63);
        } else {
            a[3] = lf[3]; a[2] = a[3] + lf[2]; a[1] = a[2] + lf[1]; a[0] = a[1] + lf[0];
            const float ex = wave_suf_add(a[0], lane) - a[0];
#pragma unroll
            for (int k = 0; k < 4; ++k) { a[k] += ex; v[k] = ig[k] - a[k]; }
            cm[3] = v[3]; cm[2] = fmaxf(cm[3], v[2]); cm[1] = fmaxf(cm[2], v[1]); cm[0] = fmaxf(cm[1], v[0]);
            const float inc = wave_suf_max(cm[0], lane); float exm = __shfl_down(inc, 1); if (lane == 63) exm = -3.0e38f;
#pragma unroll
            for (int k = 0; k < 4; ++k) cm[k] = fmaxf(cm[k], exm);
            A = __shfl(a[0], 0); vmax = __shfl(cm[0], 0);
        }
        const size_t po = (size_t)seq * SEQ + c * 256 + 4 * lane;
        *(f32x4*)(PREA + po) = (f32x4){a[0], a[1], a[2], a[3]}; *(f32x4*)(PREV + po) = (f32x4){v[0], v[1], v[2], v[3]}; *(f32x4*)(PREC + po) = (f32x4){cm[0], cm[1], cm[2], cm[3]};
#pragma unroll
        for (int k = 0; k < 4; ++k) wk[dir * 256 + 4 * lane + k] = __expf(v[k] - vmax);
        if (lane == 0) { CHS[(seq * 64 + c) * 2] = A; CHS[(seq * 64 + c) * 2 + 1] = A + vmax; }
    }
    const int sr = tid >> 4, ch0 = (tid & 15) * 8, kch = 512 + h * 128 + ch0;
    f32x16 acc[2][4];
#pragma unroll
    for (int d = 0; d < 2; ++d)
#pragma unroll
        for (int q = 0; q < 4; ++q) acc[d][q] = f32x16{};
    __syncthreads();
    const int vbA = (int)(uintptr_t)lds + (wid >> 2) * 16384 + (wid & 3) * 512 + v_rd_base(lane);
    const int kbF = (int)(uintptr_t)lds + 32768 + v_rd_base(lane), kbB = kbF + 16384;
    for (int kb = 0; kb < 4; ++kb) {
#pragma unroll
        for (int rr = 0; rr < 2; ++rr) { const int s = sr + 32 * rr, pos = c * 256 + kb * 64 + s; const size_t tok = (size_t)b * SEQ + pos;
            const bf16_t* vp = MV + tok * 1024 + h * 256 + ch0;
            const u32x4 va = *(const u32x4*)vp, vb2 = *(const u32x4*)(vp + 128);
            *(u32x4*)(lds + v_st(s, ch0)) = va; *(u32x4*)(lds + 16384 + v_st(s, ch0)) = vb2;
            float kc[8]; conv8(MQK + tok * 1024 + kch, pos, P.in[3], P.in[4], kch, kc);
            const float wf = wk[kb * 64 + s], wb = wk[256 + kb * 64 + s];
            *(u32x4*)(lds + 32768 + v_st(s, ch0)) = pack8f(kc, wf); *(u32x4*)(lds + 49152 + v_st(s, ch0)) = pack8f(kc, wb);
#pragma unroll
            for (int e = 0; e < 8; ++e) { atomicAdd(&nacc[ch0 + e], wf * kc[e]); atomicAdd(&nacc[128 + ch0 + e], wb * kc[e]); } }
        __syncthreads();
#define M1_BLK(DIR, KB, Q) do { \
          const s16x4 l0 = tr_read<v_rd_off(Q, 0, 0)>(KB), h0 = tr_read<v_rd_off(Q, 0, 1)>(KB), l1 = tr_read<v_rd_off(Q, 1, 0)>(KB), h1 = tr_read<v_rd_off(Q, 1, 1)>(KB); \
          const s16x4 l2 = tr_read<v_rd_off(Q, 2, 0)>(KB), h2 = tr_read<v_rd_off(Q, 2, 1)>(KB), l3 = tr_read<v_rd_off(Q, 3, 0)>(KB), h3 = tr_read<v_rd_off(Q, 3, 1)>(KB); \
          const s16x4 x0 = tr_read<v_rd_off(0, 0, 0)>(vbA), y0 = tr_read<v_rd_off(0, 0, 1)>(vbA), x1 = tr_read<v_rd_off(0, 1, 0)>(vbA), y1 = tr_read<v_rd_off(0, 1, 1)>(vbA); \
          const s16x4 x2 = tr_read<v_rd_off(0, 2, 0)>(vbA), y2 = tr_read<v_rd_off(0, 2, 1)>(vbA), x3 = tr_read<v_rd_off(0, 3, 0)>(vbA), y3 = tr_read<v_rd_off(0, 3, 1)>(vbA); \
          asm volatile("s_waitcnt lgkmcnt(0)" ::: "memory"); SBAR(); \
          acc[DIR][Q] = MFMA32(PKV(x0, y0), PKV(l0, h0), acc[DIR][Q]); acc[DIR][Q] = MFMA32(PKV(x1, y1), PKV(l1, h1), acc[DIR][Q]); \
          acc[DIR][Q] = MFMA32(PKV(x2, y2), PKV(l2, h2), acc[DIR][Q]); acc[DIR][Q] = MFMA32(PKV(x3, y3), PKV(l3, h3), acc[DIR][Q]); } while (0)
        M1_BLK(0, kbF, 0); M1_BLK(0, kbF, 1); M1_BLK(0, kbF, 2); M1_BLK(0, kbF, 3);
        M1_BLK(1, kbB, 0); M1_BLK(1, kbB, 1); M1_BLK(1, kbB, 2); M1_BLK(1, kbB, 3);
#undef M1_BLK
        __syncthreads();
    }
#pragma unroll
    for (int d = 0; d < 2; ++d) { const int seq = (d * 2 + b) * 4 + h; bf16_t* sp = ST + (size_t)(seq * 64 + c) * 32768;
#pragma unroll
        for (int q = 0; q < 4; ++q)
#pragma unroll
            for (int r = 0; r < 16; ++r) { const unsigned w = pk2(acc[d][q][r], 0.f); sp[(wid * 32 + crow(r, hi)) * 128 + q * 32 + r32] = (bf16_t)(w & 0xffffu); } }
    __syncthreads();
    if (tid < 256) { const int d = tid >> 7, seq = (d * 2 + b) * 4 + h; NLOC[(size_t)(seq * 64 + c) * 128 + (tid & 127)] = nacc[tid]; }
    __syncthreads();
}

DI void m2_item(const Params& P, int item) {
    const int tid = opaque_tid(), seq = item >> 4, slice = item & 15, dir = seq >> 3;
    unsigned char* dsc = (unsigned char*)P.out;
    const float* CHS = (const float*)(dsc + DO_CHS); float* NLOC = (float*)(dsc + DO_NLOC); float* MPREV = (float*)(dsc + DO_MPREV);
    bf16_t* ST = (bf16_t*)(P.ws + WS_ST);
    const size_t eo = (size_t)(slice * 16 + (tid >> 5)) * 128 + (tid & 31) * 4;
    const bool nthr = (slice == 0) && (tid < 128);
    float C0 = 0.f, C1 = 0.f, C2 = 0.f, C3 = 0.f, m = 0.f, n = 0.f;
    for (int g = 0; g < 8; ++g) {
        u32x2 sv[8]; float As[8], Ms[8], nl[8];
#pragma unroll
        for (int j = 0; j < 8; ++j) { const int st = g * 8 + j, tc = dir ? 63 - st : st; const size_t ci = (size_t)seq * 64 + tc;
            sv[j] = *(const u32x2*)(ST + ci * 32768 + eo); As[j] = CHS[ci * 2]; Ms[j] = CHS[ci * 2 + 1]; nl[j] = nthr ? NLOC[ci * 128 + tid] : 0.f; }
#pragma unroll
        for (int j = 0; j < 8; ++j) { const int st = g * 8 + j, tc = dir ? 63 - st : st; const size_t ci = (size_t)seq * 64 + tc;
            u32x2 o; o.x = pk2(C0, C1); o.y = pk2(C2, C3); *(u32x2*)(ST + ci * 32768 + eo) = o;
            if (nthr) NLOC[ci * 128 + tid] = n;
            if (slice == 0 && tid == 0) MPREV[ci] = m;
            const float mn = fmaxf(As[j] + m, Ms[j]), d1 = __expf(As[j] + m - mn), d2 = __expf(Ms[j] - mn);
            C0 = d1 * C0 + d2 * bflo(sv[j].x); C1 = d1 * C1 + d2 * bfhi(sv[j].x); C2 = d1 * C2 + d2 * bflo(sv[j].y); C3 = d1 * C3 + d2 * bfhi(sv[j].y);
            n = d1 * n + d2 * nl[j]; m = mn; }
    }
}

DI void m3_item(const Params& P, unsigned char* lds, int item) {
    const int tid = opaque_tid(), wid = __builtin_amdgcn_readfirstlane(tid >> 6), lane = tid & 63, r32 = lane & 31, hi = lane >> 5;
    const int b = item >> 10, h = (item >> 8) & 3, c = (item >> 2) & 63, jb = item & 3;
    const int rb = wid & 1, cgp = wid >> 1;
    unsigned char* dsc = (unsigned char*)P.out;
    const float* PREA = (const float*)(dsc + DO_PREA); const float* PREV = (const float*)(dsc + DO_PREV); const float* PREC = (const float*)(dsc + DO_PREC);
    const float* NPREV = (const float*)(dsc + DO_NLOC); const float* MPREV = (const float*)(dsc + DO_MPREV);
    const bf16_t* MQK = (const bf16_t*)(P.ws + WS_MQK); const bf16_t* MV = (const bf16_t*)(P.ws + WS_MV); const bf16_t* ST = (const bf16_t*)(P.ws + WS_ST);
    bf16_t* OG = (bf16_t*)(P.ws + WS_OG);
    float* vA = (float*)(lds + 73728);
    float* uJ = vA + 512;
    float* wiJ = uJ + 128;
    float* enJ = wiJ + 128;
    float* qnJ = enJ + 128;
    float* smJ = qnJ + 128;
    float* rJ = smJ + 128;
    const int seqF = b * 4 + h, seqB = (2 + b) * 4 + h;
    const int pos0 = c * 256 + jb * 64; const size_t tokq = (size_t)b * SEQ + pos0;
    if (tid < 256) { vA[tid] = PREV[(size_t)seqF * SEQ + c * 256 + tid]; vA[256 + tid] = PREV[(size_t)seqB * SEQ + c * 256 + tid]; }
    if (tid < 128) { const int d = tid >> 6, j = tid & 63, seq = d ? seqB : seqF; const size_t po = (size_t)seq * SEQ + pos0 + j;
        const float a = PREA[po], cmx = PREC[po], mp = MPREV[seq * 64 + c]; const float u = -fmaxf(mp, cmx);
        uJ[tid] = u; wiJ[tid] = __expf(mp + u); enJ[tid] = __expf(-a + u); }
    const int sr = tid >> 4, ch0 = (tid & 15) * 8;
    {
#pragma unroll
      for (int rr = 0; rr < 2; ++rr) { const int s = sr + 32 * rr; float qc[8]; conv8(MQK + (tokq + s) * 1024 + h * 128 + ch0, pos0 + s, P.in[3], P.in[4], h * 128 + ch0, qc);
          *(u32x4*)(lds + KSWZ(s, ch0 * 2)) = pack8f(qc, 0.08838834764831845f); } }
    __syncthreads();
    { const int row = tid >> 3, seg = tid & 7;
      const u32x4 qa = *(const u32x4*)(lds + KSWZ(row, seg * 32)), qb2 = *(const u32x4*)(lds + KSWZ(row, seg * 32 + 16));
      float q[16] = {bflo(qa.x), bfhi(qa.x), bflo(qa.y), bfhi(qa.y), bflo(qa.z), bfhi(qa.z), bflo(qa.w), bfhi(qa.w), bflo(qb2.x), bfhi(qb2.x), bflo(qb2.y), bfhi(qb2.y), bflo(qb2.z), bfhi(qb2.z), bflo(qb2.w), bfhi(qb2.w)};
      const float* nf = NPREV + (size_t)(seqF * 64 + c) * 128 + seg * 16; const float* nb = NPREV + (size_t)(seqB * 64 + c) * 128 + seg * 16;
      float sf = 0.f, sb = 0.f;
#pragma unroll
      for (int i = 0; i < 4; ++i) { const f32x4 a = *(const f32x4*)(nf + 4 * i), bb = *(const f32x4*)(nb + 4 * i);
#pragma unroll
          for (int e = 0; e < 4; ++e) { sf += q[4 * i + e] * a[e]; sb += q[4 * i + e] * bb[e]; } }
      sf += __shfl_xor(sf, 1); sf += __shfl_xor(sf, 2); sf += __shfl_xor(sf, 4); sb += __shfl_xor(sb, 1); sb += __shfl_xor(sb, 2); sb += __shfl_xor(sb, 4);
      if (seg == 0) { qnJ[row] = sf; qnJ[64 + row] = sb; } }
    const int jl = rb * 32 + r32;
    const float uF = uJ[jl], uB = uJ[64 + jl], wiF = wiJ[jl], wiB = wiJ[64 + jl];
    f32x16 aF[2], aB[2];
    aF[0] = f32x16{}; aF[1] = f32x16{}; aB[0] = f32x16{}; aB[1] = f32x16{};
    float sumF = 0.f, sumB = 0.f;
    const int vb = (int)(uintptr_t)lds + 32768 + (cgp >> 1) * 16384 + (cgp & 1) * 1024 + v_rd_base(lane);
    for (int kb = 0; kb < 4; ++kb) {
        __syncthreads();
#pragma unroll
        for (int rr = 0; rr < 2; ++rr) { const int s = sr + 32 * rr, pos = c * 256 + kb * 64 + s; const size_t tok = (size_t)b * SEQ + pos;
            const bf16_t* vp = MV + tok * 1024 + h * 256 + ch0;
            const u32x4 va = *(const u32x4*)vp, vb2 = *(const u32x4*)(vp + 128);
            *(u32x4*)(lds + 32768 + v_st(s, ch0)) = va; *(u32x4*)(lds + 49152 + v_st(s, ch0)) = vb2;
            float kc[8]; conv8(MQK + tok * 1024 + 512 + h * 128 + ch0, pos, P.in[3], P.in[4], 512 + h * 128 + ch0, kc);
            *(u32x4*)(lds + 16384 + KSWZ(s, ch0 * 2)) = pack8f(kc, 1.f); }
        __syncthreads();
        f32x16 p0 = f32x16{}, p1 = f32x16{};
#pragma unroll
        for (int d0 = 0; d0 < 8; ++d0) { const int cbb = (d0 * 16 + hi * 8) * 2;
            const bf16x8 k0 = *reinterpret_cast<const bf16x8*>(lds + 16384 + KSWZ(r32, cbb)), k1 = *reinterpret_cast<const bf16x8*>(lds + 16384 + KSWZ(32 + r32, cbb));
            const bf16x8 qf = *reinterpret_cast<const bf16x8*>(lds + KSWZ(rb * 32 + r32, cbb));
            p0 = MFMA32(k0, qf, p0); p1 = MFMA32(k1, qf, p1); }
        const bool diag = (kb == jb);
#define M3_DIR(ACTIVE, U, VOFF, ISF, ACC, SUM) if (ACTIVE) { f32x16 w0, w1; \
            _Pragma("unroll") for (int g4 = 0; g4 < 4; ++g4) { const f32x4 va4 = *(const f32x4*)(vA + VOFF + kb * 64 + 8 * g4 + 4 * hi), vb4 = *(const f32x4*)(vA + VOFF + kb * 64 + 32 + 8 * g4 + 4 * hi); \
                _Pragma("unroll") for (int e = 0; e < 4; ++e) { const int s0 = 8 * g4 + 4 * hi + e, s1 = 32 + s0; \
                    const bool ok0 = !diag || (ISF ? (s0 <= jl) : (s0 >= jl)), ok1 = !diag || (ISF ? (s1 <= jl) : (s1 >= jl)); \
                    w0[4 * g4 + e] = ok0 ? p0[4 * g4 + e] * __expf(U + va4[e]) : 0.f; w1[4 * g4 + e] = ok1 ? p1[4 * g4 + e] * __expf(U + vb4[e]) : 0.f; } } \
            _Pragma("unroll") for (int r = 0; r < 16; ++r) SUM += w0[r] + w1[r]; \
            bf16x8 pa0, pa1, pa2, pa3; PK4(w0, 0, pa0); PK4(w0, 8, pa1); PK4(w1, 0, pa2); PK4(w1, 8, pa3); \
            att::pv_one<0>(ACC[0], vb, pa0, pa1, pa2, pa3); att::pv_one<1>(ACC[1], vb, pa0, pa1, pa2, pa3); }
        M3_DIR(kb <= jb, uF, 0, true, aF, sumF)
        M3_DIR(kb >= jb, uB, 256, false, aB, sumB)
#undef M3_DIR
    }
    sumF += __shfl_xor(sumF, 32); sumB += __shfl_xor(sumB, 32);
    if (cgp == 0 && hi == 0) { smJ[jl] = sumF; smJ[64 + jl] = sumB; }
#define M3_QC(SEQ_, WI, ACC) do { const bf16_t* ct = ST + (size_t)((SEQ_) * 64 + c) * 32768 + (size_t)(cgp * 64 + r32) * 128 + hi * 8; \
        _Pragma("unroll") for (int ks = 0; ks < 8; ++ks) { const u32x4 qw = *reinterpret_cast<const u32x4*>(lds + KSWZ(rb * 32 + r32, (ks * 16 + hi * 8) * 2)); u32x4 sq; \
            sq.x = pk2(bflo(qw.x) * WI, bfhi(qw.x) * WI); sq.y = pk2(bflo(qw.y) * WI, bfhi(qw.y) * WI); sq.z = pk2(bflo(qw.z) * WI, bfhi(qw.z) * WI); sq.w = pk2(bflo(qw.w) * WI, bfhi(qw.w) * WI); \
            const bf16x8 qs = __builtin_bit_cast(bf16x8, sq); \
            const bf16x8 c0 = *reinterpret_cast<const bf16x8*>(ct + ks * 16), c1 = *reinterpret_cast<const bf16x8*>(ct + 32 * 128 + ks * 16); \
            ACC[0] = MFMA32(qs, c0, ACC[0]); ACC[1] = MFMA32(qs, c1, ACC[1]); } } while (0)
    M3_QC(seqF, wiF, aF); M3_QC(seqB, wiB, aB);
#undef M3_QC
    __syncthreads();
    if (tid < 128) { const float den = wiJ[tid] * qnJ[tid] + smJ[tid]; rJ[tid] = 1.f / fmaxf(fabsf(den), enJ[tid]); }
    __syncthreads();
    float* H = (float*)lds;
#pragma unroll
    for (int g4 = 0; g4 < 4; ++g4) { const f32x4 rf = *(const f32x4*)(rJ + rb * 32 + 8 * g4 + 4 * hi), rbw = *(const f32x4*)(rJ + 64 + rb * 32 + 8 * g4 + 4 * hi);
#pragma unroll
        for (int e = 0; e < 4; ++e) { const int row = rb * 32 + 8 * g4 + 4 * hi + e;
#pragma unroll
            for (int d = 0; d < 2; ++d) H[row * 260 + cgp * 64 + d * 32 + r32] = rf[e] * aF[d][4 * g4 + e] + rbw[e] * aB[d][4 * g4 + e]; } }
    __syncthreads();
    { const int row = tid >> 3, seg = tid & 7; const float* hr = H + row * 260 + seg * 32; f32x4 v[8]; float ss = 0.f;
#pragma unroll
      for (int i = 0; i < 8; ++i) { v[i] = *(const f32x4*)(hr + 4 * i); ss += (v[i][0] * v[i][0] + v[i][1] * v[i][1]) + (v[i][2] * v[i][2] + v[i][3] * v[i][3]); }
      ss += __shfl_xor(ss, 1); ss += __shfl_xor(ss, 2); ss += __shfl_xor(ss, 4);
      const float rstd = 1.f / sqrtf(ss * (1.f / 256.f) + EPS);
      bf16_t* op = OG + (tokq + row) * 1024 + h * 256 + seg * 32; const float* gp = P.in[6] + h * 256 + seg * 32;
#pragma unroll
      for (int i = 0; i < 4; ++i) { const u32x4 z = *(const u32x4*)(op + 8 * i); const f32x4 g0 = *(const f32x4*)(gp + 8 * i), g1 = *(const f32x4*)(gp + 8 * i + 4);
          const f32x4 a = v[2 * i], bq = v[2 * i + 1]; f32x4 r0, r1;
          r0[0] = a[0] * rstd * g0[0] * bflo(z.x); r0[1] = a[1] * rstd * g0[1] * bfhi(z.x); r0[2] = a[2] * rstd * g0[2] * bflo(z.y); r0[3] = a[3] * rstd * g0[3] * bfhi(z.y);
          r1[0] = bq[0] * rstd * g1[0] * bflo(z.z); r1[1] = bq[1] * rstd * g1[1] * bfhi(z.z); r1[2] = bq[2] * rstd * g1[2] * bflo(z.w); r1[3] = bq[3] * rstd * g1[3] * bfhi(z.w);
          *(u32x4*)(op + 8 * i) = pack8(r0, r1); } }
    __syncthreads();
}
}

__global__ void __launch_bounds__(512, 2) fwd_kernel(Params P) {
    extern __shared__ __attribute__((aligned(16))) unsigned char lds[];
    cg::grid_group grid = cg::this_grid();
    const int G = gridDim.x;
    unsigned char* dsc = (unsigned char*)P.out;
    PG8_LAS unsigned char* glds = (PG8_LAS unsigned char*)lds;

#ifndef PHMASK
#define PHMASK 0x7ff
#endif
#define PH(k) if constexpr ((PHMASK >> (k)) & 1)
    PH(0) phase_prep(P, lds);
    grid.sync();
    PH(1) {
        pg8::Gemm g{(const bf16_t*)(P.ws + WS_XN), (const bf16_t*)(dsc + DO_WINT), T, 4096, 1024}; pg8::StaticOrder S; S.init(T, 4096, G, (int)blockIdx.x);
        EpiProj E{P.ws, (const float*)(dsc + DO_ROPE), P.in[11], 0};
        pg8::gemm_phase<EpiProj, pg8::StaticOrder>(glds, g, S, E);
    }
    grid.sync();
    PH(2) for (int it = blockIdx.x; it < 512; it += G) ml::m1_item(P, lds, it);
    grid.sync();
    PH(3) for (int it = blockIdx.x; it < 256; it += G) ml::m2_item(P, it);
    grid.sync();
    PH(4) for (int it = blockIdx.x; it < 2048; it += G) ml::m3_item(P, lds, it);
    grid.sync();
    PH(5) {
        pg8::Gemm g{(const bf16_t*)(P.ws + WS_XN), (const bf16_t*)(dsc + DO_WINT) + (size_t)4096 * 1024, T, 6144, 1024}; pg8::StaticOrder S; S.init(T, 6144, G, (int)blockIdx.x);
        EpiProj E{P.ws, (const float*)(dsc + DO_ROPE), P.in[11], 16};
        pg8::gemm_phase<EpiProj, pg8::StaticOrder>(glds, g, S, E);
    }
    grid.sync();
    PH(6) phase_attn(P, lds);
    grid.sync();
    PH(7) {
        prep_wout(P, lds);
        __syncthreads();
        pg8::Gemm g{(const bf16_t*)(P.ws + WS_HA), (const bf16_t*)(dsc + DO_WMT), 2 * T, 2048, 1024}; F1Order S{G, (int)blockIdx.x};
        EpiY E{(const bf16_t*)(P.ws + WS_G), (bf16_t*)(P.ws + WS_Y)};
        pg8::gemm_phase<EpiY, F1Order>(glds, g, S, E);
    }
    grid.sync();
    PH(8) {
        pg8::Gemm g{(const bf16_t*)(P.ws + WS_Y), (const bf16_t*)(P.ws + WS_WOT), T, 1024, 1024}; pg8::StaticOrder S; S.init(T, 1024, G, (int)blockIdx.x);
        EpiOut E{P.out, (float*)(P.ws + WS_ROWSQ)};
        pg8::gemm_phase<EpiOut, pg8::StaticOrder>(glds, g, S, E);
    }
    grid.sync();
    PH(9) phase_final(P);
}

extern "C" void kernel_launch(void* const* d_in, const int* in_sizes, int n_in, void* d_out, int out_size, void* d_ws, size_t ws_size, hipStream_t stream) {
    static int grid = 0;
    if (grid == 0) {
        if (n_in != 14 || in_sizes[0] != T * DM || out_size != T * DM || ws_size < WS_END) {
            fprintf(stderr, "kernel_launch: unexpected shapes: n_in %d in0 %d out %d ws %zu (need %zu); nothing launched\n", n_in, n_in > 0 ? in_sizes[0] : -1, out_size, ws_size, (size_t)WS_END); grid = -1; return; }
        int dev = 0, cus = 0, per_cu = 0;
        if (hipGetDevice(&dev) != hipSuccess || hipDeviceGetAttribute(&cus, hipDeviceAttributeMultiprocessorCount, dev) != hipSuccess) { grid = -1; return; }
        if (hipFuncSetAttribute((const void*)fwd_kernel, hipFuncAttributeMaxDynamicSharedMemorySize, LDS_BYTES) != hipSuccess) { fprintf(stderr, "kernel_launch: hipFuncSetAttribute failed\n"); grid = -1; return; }
        if (hipOccupancyMaxActiveBlocksPerMultiprocessor(&per_cu, (const void*)fwd_kernel, 512, LDS_BYTES) != hipSuccess || per_cu < 1) { fprintf(stderr, "kernel_launch: occupancy query says %d blocks per CU\n", per_cu); per_cu = 1; }
        (void)hipGetLastError();
        grid = cus;
    }
    if (grid < 0) return;
    Params p{};
    for (int i = 0; i < 14; ++i) p.in[i] = (const float*)d_in[i];
    p.out = (float*)d_out; p.ws = (unsigned char*)d_ws;
    void* args[] = {&p};
    hipError_t e = hipLaunchCooperativeKernel((const void*)fwd_kernel, dim3(grid), dim3(512), args, LDS_BYTES, stream);
    if (e != hipSuccess) fprintf(stderr, "kernel_launch: cooperative launch failed: %s (grid %d)\n", hipGetErrorString(e), grid);
}
```
